# Optimizing an MI355X kernel written in HIP

```python
import jax, jax.numpy as jnp
from jax import lax
import numpy as np

D_MODEL = 2048
BATCH = 4
SEQ = 2048
DEPTH = 1
DEC_BATCH = 128
DEC_SEQ = 8
PAST_LEN = 8192
PAGE_SIZE = 128

N_META = 16
HEAD_DIM = 64
ATTN_WIDTH = D_MODEL // 2
CONV_CH = D_MODEL - ATTN_WIDTH
N_HEADS = ATTN_WIDTH // HEAD_DIM
N_KV_HEADS = 4
GQA_GROUP = N_HEADS // N_KV_HEADS
KV_WIDTH = N_KV_HEADS * HEAD_DIM
IN_COLS = ATTN_WIDTH + 2 * KV_WIDTH + 2 * CONV_CH
WINDOW = 128
BLOCK = 128
ROPE_THETA = 500000.0
ROT_DIM = HEAD_DIM // 4
CONV_K = 31
D_FF = 4 * D_MODEL
RMS_EPS = 1e-6
LN_EPS = 1e-5
MASK_VALUE = -1e30

kernel_name = 'hybrid_swa_sink_conformer_conv_decoder'


def rms_norm(x, g):
    xf = x.astype(jnp.float32)
    y = xf * lax.rsqrt(jnp.mean(xf * xf, axis=-1, keepdims=True) + RMS_EPS)
    return (y * g.astype(jnp.float32)).astype(x.dtype)


def partial_rope(x, pos):
    half = ROT_DIM // 2
    inv = jnp.power(jnp.float32(ROPE_THETA), -jnp.arange(half, dtype=jnp.float32) * 2.0 / ROT_DIM)
    ang = pos.astype(jnp.float32)[:, None] * inv[None, :]
    cos = jnp.cos(ang)[:, None, :]
    sin = jnp.sin(ang)[:, None, :]
    xr = x[..., :ROT_DIM].astype(jnp.float32)
    x1, x2 = xr[..., :half], xr[..., half:]
    rot = jnp.concatenate([x1 * cos - x2 * sin, x2 * cos + x1 * sin], axis=-1)
    return jnp.concatenate([rot.astype(x.dtype), x[..., ROT_DIM:]], axis=-1)


def mixer_inputs(h, g, w_in):
    xn = rms_norm(h, g)
    z = jnp.einsum('btd,dc->btc', xn, w_in)
    q, k, v, a, b = jnp.split(z, [ATTN_WIDTH, ATTN_WIDTH + KV_WIDTH, ATTN_WIDTH + 2 * KV_WIDTH,
                                  ATTN_WIDTH + 2 * KV_WIDTH + CONV_CH], axis=-1)
    lead = h.shape[:-1]
    q = q.reshape(lead + (N_HEADS, HEAD_DIM))
    k = k.reshape(lead + (N_KV_HEADS, HEAD_DIM))
    v = v.reshape(lead + (N_KV_HEADS, HEAD_DIM))
    u = a * jax.nn.sigmoid(b)
    return q, k, v, u


def sink_probs(s, mask, sink):
    s = jnp.where(mask, s, MASK_VALUE)
    m = jnp.maximum(jnp.max(s, axis=-1, keepdims=True), sink)
    e = jnp.exp(s - m)
    return e / (jnp.sum(e, axis=-1, keepdims=True) + jnp.exp(sink - m))


def swa_prompt(q, k, v, sinks):
    n = q.shape[0]
    pad = (-N_META) % BLOCK
    padf = lambda t: jnp.pad(t, ((0, 0), (pad, 0), (0, 0), (0, 0)))
    lp = q.shape[1] + pad
    nb = lp // BLOCK
    qb = padf(q).reshape(n, nb, BLOCK, N_KV_HEADS, GQA_GROUP, HEAD_DIM)
    kb = padf(k).reshape(n, nb, BLOCK, N_KV_HEADS, HEAD_DIM)
    vb = padf(v).reshape(n, nb, BLOCK, N_KV_HEADS, HEAD_DIM)
    prev = lambda t: jnp.pad(t, ((0, 0), (1, 0), (0, 0), (0, 0), (0, 0)))[:, :-1]
    kk = jnp.concatenate([prev(kb), kb], axis=2)
    vv = jnp.concatenate([prev(vb), vb], axis=2)
    qpos = (jnp.arange(lp, dtype=jnp.int32) - pad).reshape(nb, BLOCK)
    kpos = jnp.concatenate([qpos - BLOCK, qpos], axis=1)
    diff = qpos[:, :, None] - kpos[:, None, :]
    mask = (diff >= 0) & (diff < WINDOW) & (kpos[:, None, :] >= 0)
    s = jnp.einsum('bnqkgd,bnskd->bnkgqs', qb, kk, preferred_element_type=jnp.float32)
    s = s * (HEAD_DIM ** -0.5)
    sink = sinks.astype(jnp.float32).reshape(N_KV_HEADS, GQA_GROUP)[None, None, :, :, None, None]
    p = sink_probs(s, mask[None, :, None, None], sink)
    o = jnp.einsum('bnkgqs,bnskd->bnqkgd', p.astype(v.dtype), vv)
    return o.reshape(n, lp, ATTN_WIDTH)[:, pad:]


def swa_sample(q, kk, vv, sinks):
    n, t = q.shape[:2]
    w = kk.shape[1] - t
    qpos = PAST_LEN + jnp.arange(t, dtype=jnp.int32)
    kpos = PAST_LEN - w + jnp.arange(w + t, dtype=jnp.int32)
    diff = qpos[:, None] - kpos[None, :]
    mask = (diff >= 0) & (diff < WINDOW)
    qg = q.reshape(n, t, N_KV_HEADS, GQA_GROUP, HEAD_DIM)
    s = jnp.einsum('bqkgd,bskd->bkgqs', qg, kk, preferred_element_type=jnp.float32)
    s = s * (HEAD_DIM ** -0.5)
    sink = sinks.astype(jnp.float32).reshape(N_KV_HEADS, GQA_GROUP)[None, :, :, None, None]
    p = sink_probs(s, mask[None, None, None], sink)
    o = jnp.einsum('bkgqs,bskd->bqkgd', p.astype(vv.dtype), vv)
    return o.reshape(n, t, ATTN_WIDTH)


def conv_branch(u_hist, w_dw, b_dw, ln_g, ln_b):
    y = lax.conv_general_dilated(u_hist, w_dw[:, None, :].astype(u_hist.dtype), window_strides=(1,),
                                 padding='VALID', dimension_numbers=('NWC', 'WIO', 'NWC'),
                                 feature_group_count=CONV_CH)
    yf = (y + b_dw).astype(jnp.float32)
    mu = jnp.mean(yf, axis=-1, keepdims=True)
    var = jnp.mean(jnp.square(yf - mu), axis=-1, keepdims=True)
    yn = (yf - mu) * lax.rsqrt(var + LN_EPS) * ln_g.astype(jnp.float32) + ln_b.astype(jnp.float32)
    return jax.nn.silu(yn).astype(u_hist.dtype)


def merge_groups(attn, conv, w_out):
    return jnp.einsum('btc,cd->btd', jnp.concatenate([attn, conv], axis=-1), w_out)


def sq_relu_mlp(h, g, w_up, w_down):
    a = jax.nn.relu(jnp.einsum('btd,df->btf', rms_norm(h, g), w_up))
    return jnp.einsum('btf,fd->btd', a * a, w_down)


def setup_inputs(seed: int = 0) -> dict:
    key = jax.random.key(seed)
    ks = jax.random.split(key, 20)
    f32 = jnp.float32
    nrm = lambda k, shape, scale: jax.random.normal(k, shape, f32) * scale
    return {
        'x_prompt': nrm(ks[0], (BATCH, SEQ, D_MODEL), 1.0),
        'x_sample': nrm(ks[1], (DEC_BATCH, DEC_SEQ, D_MODEL), 1.0),
        'cache_k': nrm(ks[2], (DEPTH, DEC_BATCH, WINDOW, N_KV_HEADS, HEAD_DIM), 1.0),
        'cache_v': nrm(ks[3], (DEPTH, DEC_BATCH, WINDOW, N_KV_HEADS, HEAD_DIM), 1.0),
        'state_conv': nrm(ks[4], (DEPTH, DEC_BATCH, CONV_K - 1, CONV_CH), 0.5),
        'meta_tokens': nrm(ks[5], (N_META, D_MODEL), 1.0),
        'norm_mix': 1.0 + nrm(ks[6], (DEPTH, D_MODEL), 0.02),
        'w_in': nrm(ks[7], (DEPTH, D_MODEL, IN_COLS), D_MODEL ** -0.5),
        'attn_sinks': nrm(ks[8], (DEPTH, N_HEADS), 0.5),
        'w_dw': nrm(ks[9], (DEPTH, CONV_K, CONV_CH), CONV_K ** -0.5),
        'b_dw': nrm(ks[10], (DEPTH, CONV_CH), 0.02),
        'conv_ln_g': 1.0 + nrm(ks[11], (DEPTH, CONV_CH), 0.02),
        'conv_ln_b': nrm(ks[12], (DEPTH, CONV_CH), 0.02),
        'w_out': nrm(ks[13], (DEPTH, ATTN_WIDTH + CONV_CH, D_MODEL), (ATTN_WIDTH + CONV_CH) ** -0.5),
        'norm_mlp': 1.0 + nrm(ks[14], (DEPTH, D_MODEL), 0.02),
        'w_up': nrm(ks[15], (DEPTH, D_MODEL, D_FF), D_MODEL ** -0.5),
        'w_down': nrm(ks[16], (DEPTH, D_FF, D_MODEL), D_FF ** -0.5),
        'norm_final': 1.0 + nrm(ks[17], (D_MODEL,), 0.02),
    }


def reference(x_prompt, x_sample, cache_k, cache_v, state_conv, meta_tokens, norm_mix, w_in, attn_sinks,
              w_dw, b_dw, conv_ln_g, conv_ln_b, w_out, norm_mlp, w_up, w_down, norm_final):
    n_prompt = x_prompt.shape[0]
    meta = jnp.broadcast_to(meta_tokens.astype(x_prompt.dtype)[None], (n_prompt, N_META, D_MODEL))
    hp = jnp.concatenate([meta, x_prompt], axis=1)
    hs = x_sample
    pos_p = jnp.arange(hp.shape[1], dtype=jnp.int32)
    pos_s = PAST_LEN + jnp.arange(hs.shape[1], dtype=jnp.int32)
    buf_len = cache_k.shape[2]
    kp, vp, cp, ksl, vsl, csl = [], [], [], [], [], []
    for l in range(DEPTH):
        q, k, v, u = mixer_inputs(hp, norm_mix[l], w_in[l])
        q = partial_rope(q, pos_p)
        k = partial_rope(k, pos_p)
        attn = swa_prompt(q, k, v, attn_sinks[l])
        u_hist = jnp.pad(u, ((0, 0), (CONV_K - 1, 0), (0, 0)))
        conv = conv_branch(u_hist, w_dw[l], b_dw[l], conv_ln_g[l], conv_ln_b[l])
        hp = hp + merge_groups(attn, conv, w_out[l])
        hp = hp + sq_relu_mlp(hp, norm_mlp[l], w_up[l], w_down[l])
        kp.append(k[:, -WINDOW:])
        vp.append(v[:, -WINDOW:])
        cp.append(u_hist[:, -(CONV_K - 1):])
        q, k, v, u = mixer_inputs(hs, norm_mix[l], w_in[l])
        q = partial_rope(q, pos_s)
        k = partial_rope(k, pos_s)
        kk = jnp.concatenate([cache_k[l].astype(k.dtype), k], axis=1)
        vv = jnp.concatenate([cache_v[l].astype(v.dtype), v], axis=1)
        attn = swa_sample(q, kk, vv, attn_sinks[l])
        u_hist = jnp.concatenate([state_conv[l].astype(u.dtype), u], axis=1)
        conv = conv_branch(u_hist, w_dw[l], b_dw[l], conv_ln_g[l], conv_ln_b[l])
        hs = hs + merge_groups(attn, conv, w_out[l])
        hs = hs + sq_relu_mlp(hs, norm_mlp[l], w_up[l], w_down[l])
        ksl.append(kk[:, -buf_len:])
        vsl.append(vv[:, -buf_len:])
        csl.append(u_hist[:, -(CONV_K - 1):])
    y_prompt = rms_norm(hp, norm_final)[:, N_META:]
    y_sample = rms_norm(hs, norm_final)
    return (y_prompt, y_sample, jnp.stack(kp), jnp.stack(vp), jnp.stack(cp),
            jnp.stack(ksl), jnp.stack(vsl), jnp.stack(csl))
```

```cpp
#include <hip/hip_runtime.h>
#include <cstdio>
#include <cstdint>
namespace pg8 {
#define PG8_LAS __attribute__((address_space(3)))
typedef unsigned short bf16_t;
typedef short bf16x8 __attribute__((ext_vector_type(8)));
typedef float f32x4 __attribute__((ext_vector_type(4)));
typedef unsigned u32x4 __attribute__((ext_vector_type(4)));
constexpr int BM = 256, BK = 64, HALF = 128, HTB = HALF * BK * 2  , STAGE_BYTES = 8 * HTB, NXCD = 8, WGM = 8;

__host__ __device__ __forceinline__ int lds_byte(int r, int c) { const int st = (r >> 4) * 2 + (c >> 5), rr = r & 15, cc = c & 31, ob = rr * 64 + cc * 2; return st * 1024 + (ob ^ (((ob >> 9) & 1) << 5)); }
__host__ __device__ __forceinline__ void stage_rc(int b, int& R, int& C) { const int st = b / 1024, sb = b % 1024, swz = sb ^ (((sb >> 9) & 1) << 5); R = (st >> 1) * 16 + swz / 64; C = (st & 1) * 32 + (swz % 64) / 2; }
__host__ __device__ __forceinline__ int perm32(int rho) { const int n = rho >> 4, i = rho & 15; return 8 * (i >> 2) + 4 * n + (i & 3); }

struct Unit { int pm, pn; };
struct Gemm { const bf16_t* A; const bf16_t* Bt; int M, N, K; };

struct StaticOrder {
    int nM, nN, nwg, G, c;
    __host__ __device__ void init(int M, int N, int G_, int c_) { nM = M / BM; nN = N / BM; nwg = nM * nN; G = G_; c = c_; }
    __host__ __device__ bool next(int i, Unit& u) const {
        const long L = (long)i * G + c; if (L >= nwg) return false;
        int wgid = (int)L; { const int q = nwg / NXCD, r = nwg % NXCD, xcd = wgid % NXCD, off = wgid / NXCD; wgid = (xcd < r ? xcd * (q + 1) : r * (q + 1) + (xcd - r) * q) + off; }
        const int nig = WGM * nN, gid = wgid / nig, fm = gid * WGM, gsz = (nM - fm) < WGM ? (nM - fm) : WGM;
        u.pm = fm + ((wgid % nig) % gsz); u.pn = (wgid % nig) / gsz; return true;
    }
    __device__ __forceinline__ void a_ready(const Unit&) const {}
    __device__ __forceinline__ void done(const Unit&) const {}
};

constexpr int L_P = 2064, NB_P = 4, M_P = NB_P * L_P;
constexpr int NS_S = 128, T_S = 8, M_S = NS_S * T_S;
constexpr int M_TOK = M_P + M_S, M_PAD = 9472;
constexpr int DM = 2048, NIN = 3584, DFF = 8192;
constexpr int OFF_YP = 0, OFF_YS = 16777216, OFF_KP = 18874368, OFF_VP = 19005440, OFF_CP = 19136512,
              OFF_KS = 19259392, OFF_VS = 23453696, OFF_CS = 27648000, OUT_TOTAL = 31580160;

__device__ __forceinline__ unsigned cvt_pk_bf16(float lo, float hi) { unsigned r; asm("v_cvt_pk_bf16_f32 %0, %1, %2" : "=v"(r) : "v"(lo), "v"(hi)); return r; }
__device__ __forceinline__ u32x4 pack8(const f32x4 a, const f32x4 b) { u32x4 w; w.x = cvt_pk_bf16(a[0], a[1]); w.y = cvt_pk_bf16(a[2], a[3]); w.z = cvt_pk_bf16(b[0], b[1]); w.w = cvt_pk_bf16(b[2], b[3]); return w; }
__device__ __forceinline__ void decode_row(int row, bool& isp, int& bn, int& t) {
    if (row < M_P) { isp = true; bn = row / L_P; t = row - bn * L_P; } else { isp = false; const int s = row - M_P; bn = s >> 3; t = s & 7; }
}

struct Epi1 {
    static constexpr bool PERM = true, AFTER_DRAIN = false;
    bf16_t *Q, *Kb, *Vb, *U; const float* rope; float* out;
    __device__ __forceinline__ void operator()(const f32x4 (&acc)[2][2][4][2], const Unit& u, int wr, int wc, int fr, int fq) const {
        const int pn = u.pn;
        const int cw = wc * 32 + 8 * fq;
#pragma unroll
        for (int ai = 0; ai < 2; ++ai)
#pragma unroll
            for (int m = 0; m < 4; ++m) {
                const int row = u.pm * BM + ai * HALF + wr * 64 + m * 16 + fr;
                const bool valid = row < M_TOK;
                bool isp; int bn, t; decode_row(valid ? row : 0, isp, bn, t);
                if (pn < 5) {
                    f32x4 v[2][2];
#pragma unroll
                    for (int bj = 0; bj < 2; ++bj)
#pragma unroll
                        for (int n = 0; n < 2; ++n) v[bj][n] = acc[ai][bj][m][n];
                    if ((wc & 1) == 0) {
                        const float* rp = rope + (isp ? t : (L_P + t)) * 16;
#pragma unroll
                        for (int n = 0; n < 2; ++n) {
                            const f32x4 cs = *(const f32x4*)(rp + 4 * n), sn = *(const f32x4*)(rp + 8 + 4 * n);
#pragma unroll
                            for (int bj = 0; bj < 2; ++bj)
#pragma unroll
                                for (int e = 0; e < 4; ++e) {
                                    const float own = v[bj][n][e]; const float oth = __shfl_xor(own, 16);
                                    const float r = own * cs[e] + (fq == 0 ? -oth : oth) * sn[e];
                                    if (fq < 2) v[bj][n][e] = r;
                                }
                        }
                    }
                    if (pn < 4) {
                        if (valid) {
#pragma unroll
                            for (int bj = 0; bj < 2; ++bj)
                                *(u32x4*)(Q + (size_t)row * 1024 + pn * 256 + bj * HALF + cw) = pack8(v[bj][0] * 0.125f, v[bj][1] * 0.125f);
                        }
                    } else {
                        if (valid) {
                            float* o = nullptr;
                            if (isp) { if (t >= L_P - 128) o = out + OFF_KP + (size_t)(bn * 128 + t - (L_P - 128)) * 256; }
                            else o = out + OFF_KS + (size_t)(bn * 128 + 120 + t) * 256;
#pragma unroll
                            for (int bj = 0; bj < 2; ++bj) {
                                *(u32x4*)(Kb + (size_t)row * 256 + bj * HALF + cw) = pack8(v[bj][0], v[bj][1]);
                                if (o) { *(f32x4*)(o + bj * HALF + cw) = v[bj][0]; *(f32x4*)(o + bj * HALF + cw + 4) = v[bj][1]; }
                            }
                        }
                    }
                } else if (pn == 5) {
                    if (valid) {
                        float* o = nullptr;
                        if (isp) { if (t >= L_P - 128) o = out + OFF_VP + (size_t)(bn * 128 + t - (L_P - 128)) * 256; }
                        else o = out + OFF_VS + (size_t)(bn * 128 + 120 + t) * 256;
#pragma unroll
                        for (int bj = 0; bj < 2; ++bj) {
                            *(u32x4*)(Vb + (size_t)row * 256 + bj * HALF + cw) = pack8(acc[ai][bj][m][0], acc[ai][bj][m][1]);
                            if (o) { *(f32x4*)(o + bj * HALF + cw) = acc[ai][bj][m][0]; *(f32x4*)(o + bj * HALF + cw + 4) = acc[ai][bj][m][1]; }
                        }
                    }
                } else {
                    if (valid) {
                        f32x4 g[2];
#pragma unroll
                        for (int n = 0; n < 2; ++n)
#pragma unroll
                            for (int e = 0; e < 4; ++e) g[n][e] = acc[ai][0][m][n][e] / (1.0f + __expf(-acc[ai][1][m][n][e]));
                        const int ch = (pn - 6) * 128 + cw;
                        *(u32x4*)(U + (size_t)row * 1024 + ch) = pack8(g[0], g[1]);
                        float* o = nullptr;
                        if (isp) { if (t >= L_P - 30) o = out + OFF_CP + (size_t)(bn * 30 + t - (L_P - 30)) * 1024; }
                        else o = out + OFF_CS + (size_t)(bn * 30 + 22 + t) * 1024;
                        if (o) { *(f32x4*)(o + ch) = g[0]; *(f32x4*)(o + ch + 4) = g[1]; }
                    }
                }
                asm volatile("" ::: "memory");
            }
    }
};

struct Epi2 {
    static constexpr bool PERM = true, AFTER_DRAIN = false;
    const float *xp, *xs, *gm; float* out; bf16_t* A3; float* ss;
    __device__ __forceinline__ void operator()(const f32x4 (&acc)[2][2][4][2], const Unit& u, int wr, int wc, int fr, int fq) const {
        const int colb = u.pn * BM + wc * 32 + 8 * fq;
        f32x4 g[2][2];
#pragma unroll
        for (int bj = 0; bj < 2; ++bj)
#pragma unroll
            for (int n = 0; n < 2; ++n) g[bj][n] = *(const f32x4*)(gm + colb + bj * HALF + 4 * n);
#pragma unroll
        for (int ai = 0; ai < 2; ++ai)
#pragma unroll
            for (int m = 0; m < 4; ++m) {
                const int row = u.pm * BM + ai * HALF + wr * 64 + m * 16 + fr;
                bool isp; int bn, t; decode_row(row < M_TOK ? row : 0, isp, bn, t);
                const bool valid = (row < M_TOK) && !(isp && t < 16);
                float ssq = 0.f;
                if (valid) {
                    const size_t orow = isp ? (size_t)(bn * 2048 + t - 16) : (size_t)(row - M_P);
                    const float* src = (isp ? xp : xs) + orow * DM + colb;
                    float* dst = out + (isp ? OFF_YP : OFF_YS) + orow * DM + colb;
#pragma unroll
                    for (int bj = 0; bj < 2; ++bj) {
                        f32x4 h0 = *(const f32x4*)(src + bj * HALF), h1 = *(const f32x4*)(src + bj * HALF + 4);
                        h0 += acc[ai][bj][m][0]; h1 += acc[ai][bj][m][1];
                        *(f32x4*)(dst + bj * HALF) = h0; *(f32x4*)(dst + bj * HALF + 4) = h1;
                        ssq += (h0[0] * h0[0] + h0[1] * h0[1]) + (h0[2] * h0[2] + h0[3] * h0[3]) + (h1[0] * h1[0] + h1[1] * h1[1]) + (h1[2] * h1[2] + h1[3] * h1[3]);
                        *(u32x4*)(A3 + (size_t)row * DM + colb + bj * HALF) = pack8(h0 * g[bj][0], h1 * g[bj][1]);
                    }
                }
                ssq += __shfl_xor(ssq, 16); ssq += __shfl_xor(ssq, 32);
                if (valid && fq == 0) __hip_atomic_fetch_add(ss + row, ssq, __ATOMIC_RELAXED, __HIP_MEMORY_SCOPE_AGENT);
                asm volatile("" ::: "memory");
            }
    }
};

struct Epi3 {
    static constexpr bool PERM = true, AFTER_DRAIN = false;
    const float* ss; bf16_t* H;
    __device__ __forceinline__ void operator()(const f32x4 (&acc)[2][2][4][2], const Unit& u, int wr, int wc, int fr, int fq) const {
        const int colb = u.pn * BM + wc * 32 + 8 * fq;
#pragma unroll
        for (int ai = 0; ai < 2; ++ai)
#pragma unroll
            for (int m = 0; m < 4; ++m) {
                const int row = u.pm * BM + ai * HALF + wr * 64 + m * 16 + fr;
                const float rs = rsqrtf(ss[row] * (1.0f / DM) + 1e-6f);
#pragma unroll
                for (int bj = 0; bj < 2; ++bj) {
                    f32x4 a = acc[ai][bj][m][0] * rs, b = acc[ai][bj][m][1] * rs;
#pragma unroll
                    for (int e = 0; e < 4; ++e) { const float x = fmaxf(a[e], 0.f), y = fmaxf(b[e], 0.f); a[e] = x * x; b[e] = y * y; }
                    *(u32x4*)(H + (size_t)row * DFF + colb + bj * HALF) = pack8(a, b);
                }
            }
    }
};

struct Epi4 {
    static constexpr bool PERM = true, AFTER_DRAIN = false;
    float* out; float* ss;
    __device__ __forceinline__ void operator()(const f32x4 (&acc)[2][2][4][2], const Unit& u, int wr, int wc, int fr, int fq) const {
        const int colb = u.pn * BM + wc * 32 + 8 * fq;
#pragma unroll
        for (int ai = 0; ai < 2; ++ai)
#pragma unroll
            for (int m = 0; m < 4; ++m) {
                const int row = u.pm * BM + ai * HALF + wr * 64 + m * 16 + fr;
                bool isp; int bn, t; decode_row(row < M_TOK ? row : 0, isp, bn, t);
                const bool valid = (row < M_TOK) && !(isp && t < 16);
                float ssq = 0.f;
                if (valid) {
                    const size_t orow = isp ? (size_t)(bn * 2048 + t - 16) : (size_t)(row - M_P);
                    float* dst = out + (isp ? OFF_YP : OFF_YS) + orow * DM + colb;
#pragma unroll
                    for (int bj = 0; bj < 2; ++bj) {
                        f32x4 h0 = *(const f32x4*)(dst + bj * HALF), h1 = *(const f32x4*)(dst + bj * HALF + 4);
                        h0 += acc[ai][bj][m][0]; h1 += acc[ai][bj][m][1];
                        *(f32x4*)(dst + bj * HALF) = h0; *(f32x4*)(dst + bj * HALF + 4) = h1;
                        ssq += (h0[0] * h0[0] + h0[1] * h0[1]) + (h0[2] * h0[2] + h0[3] * h0[3]) + (h1[0] * h1[0] + h1[1] * h1[1]) + (h1[2] * h1[2] + h1[3] * h1[3]);
                    }
                }
                ssq += __shfl_xor(ssq, 16); ssq += __shfl_xor(ssq, 32);
                if (valid && fq == 0) __hip_atomic_fetch_add(ss + row, ssq, __ATOMIC_RELAXED, __HIP_MEMORY_SCOPE_AGENT);
                asm volatile("" ::: "memory");
            }
    }
};

template <class Epi, class Sched, bool ALIGN_EPI = false, bool SP2 = false>
__device__ __forceinline__ void gemm_phase(PG8_LAS unsigned char* lds, const Gemm g, const Sched& S, const Epi& E) {
    int tid_ = threadIdx.x; asm volatile("" : "+v"(tid_));
    const int tid = tid_, wid = __builtin_amdgcn_readfirstlane(tid >> 6), lane = tid & 63, wr = wid >> 2, wc = wid & 3, fr = lane & 15, fq = lane >> 4;
    const int K = g.K, nt = K / BK;
    unsigned voffA[2], voffB[2];
#pragma unroll
    for (int i = 0; i < 2; ++i) { int R, C; stage_rc(tid * 16 + i * 8192, R, C); const int Rb = Epi::PERM ? ((R & ~31) + perm32(R & 31)) : R;
        voffA[i] = (unsigned)(R * K + C) * 2u; voffB[i] = (unsigned)(Rb * K + C) * 2u; }
    const size_t kstep = (size_t)(BK * 2);
    const size_t hstep = (size_t)HALF * K * 2;
    const size_t tstep = 2 * hstep;
    const unsigned ldsw = (unsigned)wid * 1024u;
    const int aoff = lds_byte(wr * 64 + fr, fq * 8), boff = lds_byte(wc * 32 + fr, fq * 8);
#define PG8_SA(b, h) (((b) * 2 + (h)) * HTB)
#define PG8_SB(b, h) ((4 + (b) * 2 + (h)) * HTB)
#define PG8_STAGE(bufoff, gbase, voff) do { _Pragma("unroll") for (int _i = 0; _i < 2; ++_i) \
        __builtin_amdgcn_global_load_lds((const unsigned*)((const char*)(gbase) + (voff)[_i]), (PG8_LAS unsigned*)(lds + (bufoff) + ldsw + _i * 8192), 16, 0, 0); } while (0)
#define PG8_LDA(dst, b, h) do { _Pragma("unroll") for (int m = 0; m < 4; ++m) _Pragma("unroll") for (int k = 0; k < 2; ++k) dst[m][k] = *(const PG8_LAS bf16x8*)(lds + PG8_SA(b, h) + aoff + m * 2048 + k * 1024); } while (0)
#define PG8_LDB(dst, b, h) do { _Pragma("unroll") for (int n = 0; n < 2; ++n) _Pragma("unroll") for (int k = 0; k < 2; ++k) dst[n][k] = *(const PG8_LAS bf16x8*)(lds + PG8_SB(b, h) + boff + n * 2048 + k * 1024); } while (0)
#define PG8_MMA(ai, bj, At, Bt) do { __builtin_amdgcn_s_setprio(1); _Pragma("unroll") for (int m = 0; m < 4; ++m) _Pragma("unroll") for (int n = 0; n < 2; ++n) _Pragma("unroll") for (int k = 0; k < 2; ++k) \
        acc[ai][bj][m][n] = __builtin_amdgcn_mfma_f32_16x16x32_bf16(Bt[n][k], At[m][k], acc[ai][bj][m][n], 0, 0, 0); __builtin_amdgcn_s_setprio(0); } while (0)
#define PG8_WAIT_V(n) asm volatile("s_waitcnt vmcnt(" #n ")" ::: "memory")
#define PG8_WAIT_L(n) asm volatile("s_waitcnt lgkmcnt(" #n ")" ::: "memory")
#define PG8_BAR __builtin_amdgcn_s_barrier()
#define PG8_SCHED __builtin_amdgcn_sched_barrier(0)
    Unit cur, nxt; int ui = 0;
    if (!S.next(0, cur)) return;
    f32x4 acc[2][2][4][2];
#pragma unroll
    for (int a = 0; a < 2; ++a)
#pragma unroll
        for (int b = 0; b < 2; ++b)
#pragma unroll
            for (int m = 0; m < 4; ++m)
#pragma unroll
                for (int n = 0; n < 2; ++n) acc[a][b][m][n] = (f32x4){0.f, 0.f, 0.f, 0.f};
    bf16x8 At[4][2], B0[2][2], B1[2][2];
    const char* cA = (const char*)g.A + (size_t)cur.pm * tstep; const char* cB = (const char*)g.Bt + (size_t)cur.pn * tstep;
    S.a_ready(cur);
    if constexpr (SP2) {
        PG8_STAGE(PG8_SB(0, 0), cB, voffB); PG8_STAGE(PG8_SB(0, 1), cB + hstep, voffB); PG8_STAGE(PG8_SA(0, 0), cA, voffA); PG8_STAGE(PG8_SA(0, 1), cA + hstep, voffA);
        if (wr == 1) PG8_BAR;
        PG8_WAIT_V(2); PG8_BAR;
        PG8_STAGE(PG8_SB(1, 0), cB + kstep, voffB); PG8_STAGE(PG8_SA(1, 0), cA + kstep, voffA); PG8_STAGE(PG8_SB(1, 1), cB + hstep + kstep, voffB);
        PG8_WAIT_V(6); PG8_BAR;
    } else {
        PG8_STAGE(PG8_SB(0, 0), cB, voffB); PG8_STAGE(PG8_SA(0, 0), cA, voffA); PG8_STAGE(PG8_SB(0, 1), cB + hstep, voffB); PG8_STAGE(PG8_SA(0, 1), cA + hstep, voffA);
        if (wr == 1) PG8_BAR;
        PG8_WAIT_V(4); PG8_BAR;
        PG8_STAGE(PG8_SB(1, 0), cB + kstep, voffB); PG8_STAGE(PG8_SA(1, 0), cA + kstep, voffA); PG8_STAGE(PG8_SB(1, 1), cB + hstep + kstep, voffB);
        PG8_WAIT_V(6); PG8_BAR;
    }
    for (;;) {
        const bool has_next = S.next(ui + 1, nxt);
        const char* nA = has_next ? (const char*)g.A + (size_t)nxt.pm * tstep : cA; const char* nB = has_next ? (const char*)g.Bt + (size_t)nxt.pn * tstep : cB;
        for (int t = 0; t < nt; t += 2) {
            const bool last = (t == nt - 2);
            const char* a1 = cA + (size_t)(t + 1) * kstep;
            const char* a2 = last ? nA : cA + (size_t)(t + 2) * kstep; const char* b2 = last ? nB : cB + (size_t)(t + 2) * kstep;
            const char* a3 = a2 + kstep; const char* b3 = b2 + kstep;
            if (last && has_next) S.a_ready(nxt);
            if constexpr (SP2) {
            PG8_LDB(B0, 0, 0); PG8_LDB(B1, 0, 1); PG8_SCHED; PG8_LDA(At, 0, 0); PG8_STAGE(PG8_SA(1, 1), a1 + hstep, voffA);
            PG8_WAIT_V(8); PG8_WAIT_L(0); PG8_BAR; PG8_MMA(0, 0, At, B0); PG8_MMA(0, 1, At, B1); PG8_BAR; PG8_SCHED;
            PG8_LDA(At, 0, 1); PG8_STAGE(PG8_SB(0, 0), b2, voffB); PG8_STAGE(PG8_SB(0, 1), b2 + hstep, voffB); PG8_STAGE(PG8_SA(0, 0), a2, voffA);
            PG8_WAIT_V(8); PG8_WAIT_L(0); PG8_BAR; PG8_MMA(1, 0, At, B0); PG8_MMA(1, 1, At, B1); PG8_BAR; PG8_SCHED;
            PG8_LDB(B0, 1, 0); PG8_LDB(B1, 1, 1); PG8_SCHED; PG8_LDA(At, 1, 0); PG8_STAGE(PG8_SA(0, 1), a2 + hstep, voffA);
            PG8_WAIT_V(8); PG8_WAIT_L(0); PG8_BAR; PG8_MMA(0, 0, At, B0); PG8_MMA(0, 1, At, B1); PG8_BAR; PG8_SCHED;
            PG8_LDA(At, 1, 1); PG8_STAGE(PG8_SB(1, 0), b3, voffB); PG8_STAGE(PG8_SB(1, 1), b3 + hstep, voffB); PG8_STAGE(PG8_SA(1, 0), a3, voffA);
            PG8_WAIT_V(8); PG8_WAIT_L(0); PG8_BAR; PG8_MMA(1, 0, At, B0); PG8_MMA(1, 1, At, B1); PG8_BAR; PG8_SCHED;
            } else {
            PG8_LDB(B0, 0, 0); PG8_SCHED; PG8_LDA(At, 0, 0); PG8_STAGE(PG8_SA(1, 1), a1 + hstep, voffA);
            PG8_WAIT_L(8); PG8_BAR; PG8_WAIT_L(0); PG8_MMA(0, 0, At, B0); PG8_BAR; PG8_SCHED;
            PG8_LDB(B1, 0, 1); PG8_STAGE(PG8_SB(0, 0), b2, voffB);
            PG8_BAR; PG8_WAIT_L(0); PG8_MMA(0, 1, At, B1); PG8_BAR;
            PG8_LDA(At, 0, 1); PG8_STAGE(PG8_SA(0, 0), a2, voffA);
            PG8_BAR; PG8_WAIT_L(0); PG8_MMA(1, 0, At, B0); PG8_BAR; PG8_SCHED;
            PG8_STAGE(PG8_SB(0, 1), b2 + hstep, voffB);
            PG8_WAIT_V(6); PG8_BAR; PG8_MMA(1, 1, At, B1); PG8_BAR;
            PG8_LDB(B0, 1, 0); PG8_SCHED; PG8_LDA(At, 1, 0); PG8_STAGE(PG8_SA(0, 1), a2 + hstep, voffA);
            PG8_WAIT_L(8); PG8_BAR; PG8_WAIT_L(0); PG8_MMA(0, 0, At, B0); PG8_BAR; PG8_SCHED;
            PG8_LDB(B1, 1, 1); PG8_STAGE(PG8_SB(1, 0), b3, voffB);
            PG8_BAR; PG8_WAIT_L(0); PG8_MMA(0, 1, At, B1); PG8_BAR;
            PG8_LDA(At, 1, 1); PG8_STAGE(PG8_SA(1, 0), a3, voffA);
            PG8_BAR; PG8_WAIT_L(0); PG8_MMA(1, 0, At, B0); PG8_BAR; PG8_SCHED;
            PG8_STAGE(PG8_SB(1, 1), b3 + hstep, voffB);
            PG8_WAIT_V(6); PG8_BAR; PG8_MMA(1, 1, At, B1); PG8_BAR;
            }
        }
        if constexpr (ALIGN_EPI) { if (wr == 0) PG8_BAR; }
        if constexpr (!Epi::AFTER_DRAIN) { E(acc, cur, wr, wc, fr, fq); S.done(cur); }
        if (!has_next) break;
#pragma unroll
        for (int a = 0; a < 2; ++a)
#pragma unroll
            for (int b = 0; b < 2; ++b)
#pragma unroll
                for (int m = 0; m < 4; ++m)
#pragma unroll
                    for (int n = 0; n < 2; ++n) acc[a][b][m][n] = (f32x4){0.f, 0.f, 0.f, 0.f};
        cur = nxt; cA = nA; cB = nB; ++ui;
        if constexpr (ALIGN_EPI) { if (wr == 1) PG8_BAR; }
    }
    PG8_WAIT_V(0);
    if constexpr (!ALIGN_EPI) { if (wr == 0) PG8_BAR; }
    PG8_BAR;
    if constexpr (Epi::AFTER_DRAIN) { E.fused(acc, cur, wr, wc, fr, fq, lds, wid, lane); S.done(cur); }
#undef PG8_SA
#undef PG8_SB
#undef PG8_STAGE
#undef PG8_LDA
#undef PG8_LDB
#undef PG8_MMA
#undef PG8_WAIT_V
#undef PG8_WAIT_L
#undef PG8_BAR
#undef PG8_SCHED
}
}

#include <hip/hip_cooperative_groups.h>
namespace cg = cooperative_groups;
using namespace pg8;
#define LAS __attribute__((address_space(3)))
typedef unsigned v2u __attribute__((ext_vector_type(2)));
typedef float f32x2 __attribute__((ext_vector_type(2)));
typedef short s16x4 __attribute__((ext_vector_type(4)));
typedef float f32x16 __attribute__((ext_vector_type(16)));

constexpr size_t MiB = 1u << 20;
constexpr size_t WS_SS1 = 0, WS_SS2 = 65536, WS_ROPE = 131072;
constexpr size_t WS_WUP = 1 * MiB, WS_WDN = 33 * MiB, WS_XN = 65 * MiB, WS_H = 102 * MiB;
constexpr size_t WS_WIN = 102 * MiB, WS_WOUT = 116 * MiB, WS_Q = 124 * MiB, WS_K = 143 * MiB, WS_V = 148 * MiB, WS_U = 153 * MiB, WS_MIX = 172 * MiB;
constexpr size_t WS_END = 250 * MiB;
constexpr int LDS_BYTES = 135168;
constexpr int NROPE = L_P + T_S;

#define LDS_WAIT() asm volatile("s_waitcnt lgkmcnt(0)" ::: "memory")
__device__ __forceinline__ unsigned f2bf(float f) { unsigned u = __builtin_bit_cast(unsigned, f); return (u + 0x7fffu + ((u >> 16) & 1u)) >> 16; }
__device__ __forceinline__ unsigned pk2(float lo, float hi) { return f2bf(lo) | (f2bf(hi) << 16); }
__device__ __forceinline__ float wave_sum(float v) {
#pragma unroll
    for (int o = 1; o < 64; o <<= 1) v += __shfl_xor(v, o);
    return v;
}

__device__ __forceinline__ void transpose_item(const float* W, int K, int N, bf16_t* WT, int k0, int n0, int drow0, LAS float* scr, int lane) {
#pragma unroll 8
    for (int i = 0; i < 32; ++i) { const int kk = 2 * i + (lane >> 5); scr[kk * 33 + (lane & 31)] = W[(size_t)(k0 + kk) * N + n0 + (lane & 31)]; }
    LDS_WAIT();
    const int c = lane & 7;
#pragma unroll
    for (int j = 0; j < 4; ++j) { const int n = (lane >> 3) + 8 * j; const LAS float* s = scr + (8 * c) * 33 + n;
        u32x4 o; o.x = pk2(s[0 * 33], s[1 * 33]); o.y = pk2(s[2 * 33], s[3 * 33]); o.z = pk2(s[4 * 33], s[5 * 33]); o.w = pk2(s[6 * 33], s[7 * 33]);
        *(u32x4*)(WT + (size_t)(drow0 + n) * K + k0 + 8 * c) = o; }
    LDS_WAIT();
}
__device__ __forceinline__ int map_in(int n) {
    if (n < 1536) return n;
    if (n < 2560) { const int c = n - 1536; return 1536 + 256 * (c >> 7) + (c & 127); }
    const int c = n - 2560; return 1536 + 256 * (c >> 7) + 128 + (c & 127);
}

struct Args { const float* in[18]; float* out; unsigned char* ws; };

__device__ __forceinline__ void p0_prologue(const Args& a, LAS unsigned char* lds, int tid, int lane, int wid) {
    unsigned char* ws = a.ws;
    LAS float* scr = (LAS float*)(lds + wid * 16384);
    const int gw = blockIdx.x * 8 + wid, NGW = gridDim.x * 8;
    const int gt = blockIdx.x * 512 + tid, NGT = gridDim.x * 512;
    for (int i = gt; i < M_PAD; i += NGT) { ((float*)(ws + WS_SS1))[i] = 0.f; ((float*)(ws + WS_SS2))[i] = 0.f; }
    for (int i = gt; i < NROPE * 8; i += NGT) {
        const int p = i >> 3, j = i & 7; const int pos = p < L_P ? p : 8192 + (p - L_P);
        const float inv = powf(500000.0f, -(float)j * 0.125f); const float ang = (float)pos * inv;
        float* rt = (float*)(ws + WS_ROPE) + p * 16; rt[j] = cosf(ang); rt[8 + j] = sinf(ang);
    }
    {
        const float* gmix = a.in[6]; bf16_t* XN = (bf16_t*)(ws + WS_XN);
        for (int m = gw; m < M_TOK; m += NGW) {
            const float* src;
            if (m < M_P) { const int b = m / L_P, t = m - b * L_P; src = t < 16 ? a.in[5] + (size_t)t * DM : a.in[0] + (size_t)(b * 2048 + t - 16) * DM; }
            else src = a.in[1] + (size_t)(m - M_P) * DM;
            f32x4 v[8]; float s = 0.f;
#pragma unroll
            for (int j = 0; j < 8; ++j) { v[j] = ((const f32x4*)src)[lane + 64 * j]; s += (v[j][0] * v[j][0] + v[j][1] * v[j][1]) + (v[j][2] * v[j][2] + v[j][3] * v[j][3]); }
            const float rs = rsqrtf(wave_sum(s) * (1.0f / DM) + 1e-6f);
#pragma unroll
            for (int j = 0; j < 8; ++j) { const f32x4 g = ((const f32x4*)gmix)[lane + 64 * j]; v2u o; o.x = pk2(v[j][0] * rs * g[0], v[j][1] * rs * g[1]); o.y = pk2(v[j][2] * rs * g[2], v[j][3] * rs * g[3]);
                ((v2u*)(XN + (size_t)m * DM))[lane + 64 * j] = o; }
        }
    }
    constexpr int I_IN = 32 * 112, I_OUT = 32 * 64, I_UP = 32 * 256, I_DN = 128 * 64, NITEMS = I_IN + I_OUT + I_UP + I_DN;
    for (int it = gw; it < NITEMS; it += NGW) {
        int r = it;
        if (r < I_IN) { const int kb = r / 112, nb = r % 112; transpose_item(a.in[7], DM, NIN, (bf16_t*)(ws + WS_WIN), 64 * kb, 32 * nb, map_in(32 * nb), scr, lane); continue; } r -= I_IN;
        if (r < I_OUT) { const int kb = r / 64, nb = r % 64; transpose_item(a.in[13], DM, DM, (bf16_t*)(ws + WS_WOUT), 64 * kb, 32 * nb, 32 * nb, scr, lane); continue; } r -= I_OUT;
        if (r < I_UP) { const int kb = r / 256, nb = r % 256; transpose_item(a.in[15], DM, DFF, (bf16_t*)(ws + WS_WUP), 64 * kb, 32 * nb, 32 * nb, scr, lane); continue; } r -= I_UP;
        { const int kb = r / 64, nb = r % 64; transpose_item(a.in[16], DFF, DM, (bf16_t*)(ws + WS_WDN), 64 * kb, 32 * nb, 32 * nb, scr, lane); }
    }
}

constexpr int KPITCH = 144, VPITCH = 392, VT_OFF = 27648;
__device__ __forceinline__ void attn_core(const bf16x8 (&qf)[4], LAS const unsigned char* Kl, LAS const unsigned char* Vl, int lo, int hi_, float sink, int hi, f32x16 (&o)[2]) {
    f32x16 sc[5];
#pragma unroll
    for (int kb = 0; kb < 5; ++kb) {
#pragma unroll
        for (int i = 0; i < 16; ++i) sc[kb][i] = 0.f;
#pragma unroll
        for (int s = 0; s < 4; ++s) { const bf16x8 kf = *(LAS const bf16x8*)(Kl + kb * (32 * KPITCH) + s * 32); sc[kb] = __builtin_amdgcn_mfma_f32_32x32x16_bf16(kf, qf[s], sc[kb], 0, 0, 0); }
        asm volatile("" ::: "memory");
    }
    float mx = sink;
#pragma unroll
    for (int kb = 0; kb < 5; ++kb)
#pragma unroll
        for (int i = 0; i < 16; ++i) { const int j = 32 * kb + (i & 3) + 8 * (i >> 2) + 4 * hi; const bool ok = (j >= lo) && (j <= hi_); const float v = ok ? sc[kb][i] : -1e30f; sc[kb][i] = v; mx = fmaxf(mx, v); }
    mx = fmaxf(mx, __shfl_xor(mx, 32));
    float sum = 0.f;
#pragma unroll
    for (int kb = 0; kb < 5; ++kb)
#pragma unroll
        for (int i = 0; i < 16; ++i) { const float e = __expf(sc[kb][i] - mx); sc[kb][i] = e; sum += e; }
    sum += __shfl_xor(sum, 32);
    sum += __expf(sink - mx);
    const float inv = 1.0f / sum;
#pragma unroll
    for (int i = 0; i < 16; ++i) { o[0][i] = 0.f; o[1][i] = 0.f; }
#pragma unroll
    for (int kb = 0; kb < 5; ++kb)
#pragma unroll
        for (int s = 0; s < 2; ++s) {
            u32x4 pw; pw.x = cvt_pk_bf16(sc[kb][8 * s + 0], sc[kb][8 * s + 1]); pw.y = cvt_pk_bf16(sc[kb][8 * s + 2], sc[kb][8 * s + 3]);
            pw.z = cvt_pk_bf16(sc[kb][8 * s + 4], sc[kb][8 * s + 5]); pw.w = cvt_pk_bf16(sc[kb][8 * s + 6], sc[kb][8 * s + 7]);
            const bf16x8 pf = __builtin_bit_cast(bf16x8, pw);
#pragma unroll
            for (int db = 0; db < 2; ++db) {
                LAS const unsigned char* vp = Vl + db * (32 * VPITCH) + (32 * kb + 16 * s) * 2;
                const s16x4 va = *(LAS const s16x4*)vp, vb = *(LAS const s16x4*)(vp + 16);
                const bf16x8 vf = (bf16x8){va[0], va[1], va[2], va[3], vb[0], vb[1], vb[2], vb[3]};
                o[db] = __builtin_amdgcn_mfma_f32_32x32x16_bf16(vf, pf, o[db], 0, 0, 0);
            }
            asm volatile("" ::: "memory");
        }
#pragma unroll
    for (int i = 0; i < 16; ++i) { o[0][i] *= inv; o[1][i] *= inv; }
}
__device__ __forceinline__ void attn_store(bf16_t* dst  , const f32x16 (&o)[2], int hi) {
#pragma unroll
    for (int db = 0; db < 2; ++db)
#pragma unroll
        for (int g4 = 0; g4 < 4; ++g4) { v2u w; w.x = cvt_pk_bf16(o[db][4 * g4], o[db][4 * g4 + 1]); w.y = cvt_pk_bf16(o[db][4 * g4 + 2], o[db][4 * g4 + 3]);
            *(v2u*)(dst + 32 * db + 8 * g4 + 4 * hi) = w; }
}
__device__ __forceinline__ void lds_put_kv(LAS unsigned char* lds, int j, int c8, const u32x4 kq, const u32x4 vq) {
    *(LAS u32x4*)(lds + j * KPITCH + c8 * 16) = kq;
    LAS unsigned short* vt = (LAS unsigned short*)(lds + VT_OFF + (c8 * 8) * VPITCH + j * 2);
    vt[0 * (VPITCH / 2)] = (unsigned short)(vq.x & 0xffffu); vt[1 * (VPITCH / 2)] = (unsigned short)(vq.x >> 16);
    vt[2 * (VPITCH / 2)] = (unsigned short)(vq.y & 0xffffu); vt[3 * (VPITCH / 2)] = (unsigned short)(vq.y >> 16);
    vt[4 * (VPITCH / 2)] = (unsigned short)(vq.z & 0xffffu); vt[5 * (VPITCH / 2)] = (unsigned short)(vq.z >> 16);
    vt[6 * (VPITCH / 2)] = (unsigned short)(vq.w & 0xffffu); vt[7 * (VPITCH / 2)] = (unsigned short)(vq.w >> 16);
}
__device__ __forceinline__ void attn_prompt_unit(const Args& a, LAS unsigned char* lds, int b, int kvh, int ch, int tid, int lane, int wid) {
    unsigned char* ws = a.ws;
    const bf16_t* Q = (const bf16_t*)(ws + WS_Q); const bf16_t* Kb = (const bf16_t*)(ws + WS_K); const bf16_t* Vb = (const bf16_t*)(ws + WS_V); bf16_t* MIX = (bf16_t*)(ws + WS_MIX);
    const int p0 = ch * 64;
    for (int i = tid; i < 192 * 8; i += 512) {
        const int j = i >> 3, c8 = i & 7, kp = p0 - 128 + j;
        u32x4 kq = (u32x4){0u, 0u, 0u, 0u}, vq = (u32x4){0u, 0u, 0u, 0u};
        if (kp >= 0 && kp < L_P) { const size_t off = (size_t)(b * L_P + kp) * 256 + kvh * 64 + c8 * 8; kq = *(const u32x4*)(Kb + off); vq = *(const u32x4*)(Vb + off); }
        lds_put_kv(lds, j, c8, kq, vq);
    }
    __syncthreads();
    {
        const int g = wid >> 1, half = wid & 1, r = lane & 31, hi = lane >> 5;
        const int qp = p0 + 32 * half + r;
        if (p0 + 32 * half < L_P) {
            const int qrow = b * L_P + (qp < L_P ? qp : L_P - 1), head = kvh * 4 + g;
            bf16x8 qf[4];
#pragma unroll
            for (int s = 0; s < 4; ++s) qf[s] = *(const bf16x8*)(Q + (size_t)qrow * 1024 + head * 64 + 16 * s + 8 * hi);
            const int lo0 = 128 - p0 - 32 * half, lo = (r + 1) > lo0 ? (r + 1) : lo0;
            f32x16 o[2];
            attn_core(qf, lds + (32 * half + r) * KPITCH + hi * 16, lds + VT_OFF + r * VPITCH + (32 * half + 4 * hi) * 2, lo, 128 + r, a.in[8][head], hi, o);
            if (qp < L_P) attn_store(MIX + (size_t)(b * L_P + qp) * DM + head * 64, o, hi);
        }
    }
    __syncthreads();
}
__device__ __forceinline__ void attn_sample_unit(const Args& a, LAS unsigned char* lds, int n, int kvh, int tid, int lane, int wid) {
    unsigned char* ws = a.ws;
    const bf16_t* Q = (const bf16_t*)(ws + WS_Q); const bf16_t* Kb = (const bf16_t*)(ws + WS_K); const bf16_t* Vb = (const bf16_t*)(ws + WS_V); bf16_t* MIX = (bf16_t*)(ws + WS_MIX);
    for (int i = tid; i < 160 * 8; i += 512) {
        const int j = i >> 3, c8 = i & 7;
        u32x4 kq = (u32x4){0u, 0u, 0u, 0u}, vq = (u32x4){0u, 0u, 0u, 0u};
        if (j < 128) {
            const size_t off = ((size_t)(n * 128 + j) * 4 + kvh) * 64 + c8 * 8;
            const f32x4 k0 = *(const f32x4*)(a.in[2] + off), k1 = *(const f32x4*)(a.in[2] + off + 4), v0 = *(const f32x4*)(a.in[3] + off), v1 = *(const f32x4*)(a.in[3] + off + 4);
            if (j >= 8) { const size_t oo = ((size_t)(n * 128 + j - 8) * 4 + kvh) * 64 + c8 * 8;
                *(f32x4*)(a.out + OFF_KS + oo) = k0; *(f32x4*)(a.out + OFF_KS + oo + 4) = k1; *(f32x4*)(a.out + OFF_VS + oo) = v0; *(f32x4*)(a.out + OFF_VS + oo + 4) = v1; }
            kq = pack8(k0, k1); vq = pack8(v0, v1);
        } else if (j < 136) {
            const size_t off = (size_t)(M_P + n * 8 + (j - 128)) * 256 + kvh * 64 + c8 * 8; kq = *(const u32x4*)(Kb + off); vq = *(const u32x4*)(Vb + off);
        }
        lds_put_kv(lds, j, c8, kq, vq);
    }
    __syncthreads();
    if (wid == 0) {
        const int r = lane & 31, hi = lane >> 5, g = r >> 3, t = r & 7, head = kvh * 4 + g, qrow = M_P + n * 8 + t;
        bf16x8 qf[4];
#pragma unroll
        for (int s = 0; s < 4; ++s) qf[s] = *(const bf16x8*)(Q + (size_t)qrow * 1024 + head * 64 + 16 * s + 8 * hi);
        f32x16 o[2];
        attn_core(qf, lds + r * KPITCH + hi * 16, lds + VT_OFF + r * VPITCH + (4 * hi) * 2, t + 1, 128 + t, a.in[8][head], hi, o);
        attn_store(MIX + (size_t)qrow * DM + head * 64, o, hi);
    }
    __syncthreads();
}

template <int T, bool SAMPLE>
__device__ __forceinline__ void conv_unit(const Args& a, LAS unsigned char* lds, int seq, int t0, int tid, int lane, int wid) {
    unsigned char* ws = a.ws;
    const bf16_t* U = (const bf16_t*)(ws + WS_U); bf16_t* MIX = (bf16_t*)(ws + WS_MIX);
    LAS float* red = (LAS float*)lds;
    const int c = 2 * tid;
    f32x2 w[31];
#pragma unroll
    for (int j = 0; j < 31; ++j) w[j] = *(const f32x2*)(a.in[9] + j * 1024 + c);
    const f32x2 bias = *(const f32x2*)(a.in[10] + c);
    f32x2 y[T];
#pragma unroll
    for (int t = 0; t < T; ++t) y[t] = bias;
#pragma unroll
    for (int r = 0; r < T + 30; ++r) {
        f32x2 uv = (f32x2){0.f, 0.f};
        if (SAMPLE) {
            if (r < 30) { uv = *(const f32x2*)(a.in[4] + ((size_t)seq * 30 + r) * 1024 + c); if (r >= 8) *(f32x2*)(a.out + OFF_CS + ((size_t)seq * 30 + r - 8) * 1024 + c) = uv; }
            else { const unsigned x = *(const unsigned*)(U + (size_t)(M_P + seq * 8 + (r - 30)) * 1024 + c); uv[0] = __uint_as_float(x << 16); uv[1] = __uint_as_float(x & 0xffff0000u); }
        } else {
            const int p = t0 - 30 + r;
            if (p >= 0) { const unsigned x = *(const unsigned*)(U + (size_t)(seq * L_P + p) * 1024 + c); uv[0] = __uint_as_float(x << 16); uv[1] = __uint_as_float(x & 0xffff0000u); }
        }
#pragma unroll
        for (int t = 0; t < T; ++t) { if (r - t >= 0 && r - t <= 30) y[t] += w[r - t] * uv; }
    }
#pragma unroll
    for (int t = 0; t < T; ++t) {
        const float s1 = wave_sum(y[t][0] + y[t][1]), s2 = wave_sum(y[t][0] * y[t][0] + y[t][1] * y[t][1]);
        if (lane == 0) { red[wid * 32 + t] = s1; red[wid * 32 + 16 + t] = s2; }
    }
    __syncthreads();
    if (tid < 32) { float s = 0.f;
#pragma unroll
        for (int k = 0; k < 8; ++k) s += red[k * 32 + tid];
        red[256 + tid] = s; }
    __syncthreads();
    const f32x2 lg = *(const f32x2*)(a.in[11] + c), lb = *(const f32x2*)(a.in[12] + c);
#pragma unroll
    for (int t = 0; t < T; ++t) {
        const float mu = red[256 + t] * (1.0f / 1024.0f), var = red[256 + 16 + t] * (1.0f / 1024.0f) - mu * mu, rstd = rsqrtf(var + 1e-5f);
        const float y0 = (y[t][0] - mu) * rstd * lg[0] + lb[0], y1 = (y[t][1] - mu) * rstd * lg[1] + lb[1];
        const float o0 = y0 / (1.0f + __expf(-y0)), o1 = y1 / (1.0f + __expf(-y1));
        const size_t row = SAMPLE ? (size_t)(M_P + seq * 8 + t) : (size_t)(seq * L_P + t0 + t);
        *(unsigned*)(MIX + row * DM + 1024 + c) = cvt_pk_bf16(o0, o1);
    }
    __syncthreads();
}

__global__ void __launch_bounds__(512, 2) fwd_kernel(Args a) {
    extern __shared__ __attribute__((aligned(16))) unsigned char lds_raw[];
    LAS unsigned char* lds = (LAS unsigned char*)lds_raw;
    cg::grid_group grid = cg::this_grid();
    int tid = threadIdx.x, lane = tid & 63, wid = __builtin_amdgcn_readfirstlane(tid >> 6);
    unsigned char* ws = a.ws;
    const int G = gridDim.x;
#define RELAUNDER() do { asm volatile("" : "+v"(tid)); lane = tid & 63; wid = __builtin_amdgcn_readfirstlane(tid >> 6); } while (0)

    p0_prologue(a, lds, tid, lane, wid);
    grid.sync();

    {
        Gemm g{(const bf16_t*)(ws + WS_XN), (const bf16_t*)(ws + WS_WIN), M_PAD, NIN, DM}; StaticOrder S; S.init(M_PAD, NIN, G, (int)blockIdx.x);
        Epi1 E{(bf16_t*)(ws + WS_Q), (bf16_t*)(ws + WS_K), (bf16_t*)(ws + WS_V), (bf16_t*)(ws + WS_U), (const float*)(ws + WS_ROPE), a.out};
        gemm_phase<Epi1, StaticOrder, true, true>(lds, g, S, E);
    }
    grid.sync();

    {
        constexpr int NAP = NB_P * 4 * 33, NCP = NB_P * 129, NCS = NS_S, NAS = NS_S * 4, NU = NAP + NCP + NCS + NAS;
        for (int u = blockIdx.x; u < NU; u += G) {
            RELAUNDER();
            if (u < NAP) { const int b = u / 132, rem = u % 132; attn_prompt_unit(a, lds, b, rem / 33, rem % 33, tid, lane, wid); }
            else if (u < NAP + NCP) { const int i = u - NAP; conv_unit<16, false>(a, lds, i / 129, (i % 129) * 16, tid, lane, wid); }
            else if (u < NAP + NCP + NCS) { conv_unit<8, true>(a, lds, u - NAP - NCP, 0, tid, lane, wid); }
            else { const int i = u - NAP - NCP - NCS; attn_sample_unit(a, lds, i >> 2, i & 3, tid, lane, wid); }
        }
    }
    grid.sync();

    {
        Gemm g{(const bf16_t*)(ws + WS_MIX), (const bf16_t*)(ws + WS_WOUT), M_PAD, DM, DM}; StaticOrder S; S.init(M_PAD, DM, G, (int)blockIdx.x);
        Epi2 E{a.in[0], a.in[1], a.in[14], a.out, (bf16_t*)(ws + WS_XN), (float*)(ws + WS_SS1)};
        gemm_phase<Epi2, StaticOrder, true, true>(lds, g, S, E);
    }
    grid.sync();

    {
        Gemm g{(const bf16_t*)(ws + WS_XN), (const bf16_t*)(ws + WS_WUP), M_PAD, DFF, DM}; StaticOrder S; S.init(M_PAD, DFF, G, (int)blockIdx.x);
        Epi3 E{(const float*)(ws + WS_SS1), (bf16_t*)(ws + WS_H)};
        gemm_phase<Epi3, StaticOrder, true, true>(lds, g, S, E);
    }
    grid.sync();

    {
        Gemm g{(const bf16_t*)(ws + WS_H), (const bf16_t*)(ws + WS_WDN), M_PAD, DM, DFF}; StaticOrder S; S.init(M_PAD, DM, G, (int)blockIdx.x);
        Epi4 E{a.out, (float*)(ws + WS_SS2)};
        gemm_phase<Epi4, StaticOrder, true, true>(lds, g, S, E);
    }
    grid.sync();

    {
        RELAUNDER();
        const float* gf = a.in[17]; const float* ss2 = (const float*)(ws + WS_SS2);
        for (int o = blockIdx.x * 8 + wid; o < 8192 + 1024; o += G * 8) {
            const int m = o < 8192 ? (o >> 11) * L_P + 16 + (o & 2047) : M_P + (o - 8192);
            const float rs = rsqrtf(ss2[m] * (1.0f / DM) + 1e-6f);
            f32x4* p = (f32x4*)(a.out + (size_t)o * DM);
#pragma unroll
            for (int j = 0; j < 8; ++j) { const f32x4 g = ((const f32x4*)gf)[lane + 64 * j]; f32x4 v = p[lane + 64 * j]; v = v * rs * g; p[lane + 64 * j] = v; }
        }
    }
}

extern "C" void kernel_launch(void* const* d_in, const int* in_sizes, int n_in, void* d_out, int out_size, void* d_ws, size_t ws_size, hipStream_t stream) {
    static int grid = 0;
    if (grid == 0) {
        if (n_in != 18 || out_size != OUT_TOTAL || ws_size < WS_END) { fprintf(stderr, "kernel_launch: unexpected shapes: n_in %d out %d ws %zu\n", n_in, out_size, ws_size); grid = -1; return; }
        int dev = 0, cus = 0, per_cu = 0;
        hipGetDevice(&dev); hipDeviceGetAttribute(&cus, hipDeviceAttributeMultiprocessorCount, dev);
        if (hipFuncSetAttribute((const void*)fwd_kernel, hipFuncAttributeMaxDynamicSharedMemorySize, LDS_BYTES) != hipSuccess) { fprintf(stderr, "kernel_launch: hipFuncSetAttribute failed\n"); grid = -1; return; }
        if (hipOccupancyMaxActiveBlocksPerMultiprocessor(&per_cu, (const void*)fwd_kernel, 512, LDS_BYTES) != hipSuccess || per_cu < 1) { fprintf(stderr, "kernel_launch: occupancy query says %d\n", per_cu); per_cu = 1; }
        (void)hipGetLastError();
        grid = cus * 1;
    }
    if (grid < 0) return;
    Args a{};
    for (int i = 0; i < 18; ++i) a.in[i] = (const float*)d_in[i];
    a.out = (float*)d_out; a.ws = (unsigned char*)d_ws;
    void* args[] = {&a};
    hipError_t e = hipLaunchCooperativeKernel((const void*)fwd_kernel, dim3(grid), dim3(512), args, LDS_BYTES, stream);
    if (e != hipSuccess) fprintf(stderr, "kernel_launch: cooperative launch failed: %s (grid %d)\n", hipGetErrorString(e), grid);
}
```
